# Optimizing an MI355X kernel written in HIP

```python
import jax, jax.numpy as jnp
from jax import lax
import numpy as np

D_MODEL = 1024
BATCH = 2
SEQ = 16384
DEPTH = 2
DEC_BATCH = 16
DEC_SEQ = 64
PAST_LEN = 2048

CHUNK = 64
EPS = 1e-6
D_MIX = D_MODEL
D_CONV = D_MIX // 2
CONV_W = 3
D_MLSTM = D_MIX - D_CONV
MLSTM_HEADS = 4
MLSTM_HD = D_MLSTM // MLSTM_HEADS
N_MEM = 256
MEM_HEADS = 4
MEM_HD = D_MODEL // MEM_HEADS
D_FF = 2816
FF_CONV_W = 3
D_IN = 3 * D_CONV + 4 * D_MLSTM + 2 * MLSTM_HEADS
SPLITS = (D_CONV, 2 * D_CONV, 3 * D_CONV, 3 * D_CONV + D_MLSTM, 3 * D_CONV + 2 * D_MLSTM,
          3 * D_CONV + 3 * D_MLSTM, 3 * D_CONV + 4 * D_MLSTM)

kernel_name = 'hymba_conv_mlstm_streaming_step'


def rms_norm(x, g):
    xf = x.astype(jnp.float32)
    y = xf * lax.rsqrt(jnp.mean(xf * xf, axis=-1, keepdims=True) + EPS)
    return (y * g.astype(jnp.float32)).astype(x.dtype)


def causal_dwconv(u, buf, w):
    T = u.shape[1]
    ext = jnp.concatenate([buf.astype(u.dtype), u], axis=1)
    y = ext[:, 0:T] * w[0]
    for j in range(1, w.shape[0]):
        y = y + ext[:, j:j + T] * w[j]
    return y, ext[:, T:]


def mlstm_chunkwise(q, k, v, i_pre, logf, C0, n0, m0):
    B, H, T, DH = q.shape
    L = min(CHUNK, T)
    NC = T // L

    def chunks(a):
        return jnp.moveaxis(a.reshape(a.shape[:2] + (NC, L) + a.shape[3:]), 2, 0)

    causal = jnp.tril(jnp.ones((L, L), dtype=bool))

    def step(carry, blk):
        C, n, m = carry
        qb, kb, vb, ib, fb = blk
        bcum = jnp.cumsum(fb, axis=-1)
        d_log = bcum[..., :, None] - bcum[..., None, :] + ib[..., None, :]
        d_log = jnp.where(causal, d_log, -jnp.inf)
        inter_log = bcum + m[..., None]
        m_t = jnp.maximum(jnp.max(d_log, axis=-1), inter_log)
        s = jnp.einsum('bhtd,bhsd->bhts', qb, kb) * jnp.exp(d_log - m_t[..., None])
        w_inter = jnp.exp(inter_log - m_t)
        num = jnp.einsum('bhts,bhse->bhte', s, vb) + w_inter[..., None] * jnp.einsum('bhtd,bhde->bhte', qb, C)
        den = jnp.sum(s, axis=-1) + w_inter * jnp.einsum('bhtd,bhd->bht', qb, n)
        h = num / jnp.maximum(jnp.abs(den), jnp.exp(-m_t))[..., None]
        m_new = m_t[..., -1]
        w_s = jnp.exp(bcum[..., -1:] - bcum + ib - m_new[..., None])
        w_c = jnp.exp(bcum[..., -1] + m - m_new)
        C_new = w_c[..., None, None] * C + jnp.einsum('bhs,bhsd,bhse->bhde', w_s, kb, vb)
        n_new = w_c[..., None] * n + jnp.einsum('bhs,bhsd->bhd', w_s, kb)
        return (C_new, n_new, m_new), h

    (C, n, m), hs = lax.scan(step, (C0, n0, m0),
                             (chunks(q), chunks(k), chunks(v), chunks(i_pre), chunks(logf)))
    h = jnp.moveaxis(hs, 0, 2).reshape(B, H, T, DH)
    return h, C, n, m


def token_mixer(xn, conv_buf, C0, n0, m0, w_in, b_gates, conv_w, mlstm_norm_w, w_out):
    B, T, _ = xn.shape
    f32 = jnp.float32
    xc, g_b, g_c, q, k, v, o, gates = jnp.split(xn @ w_in, SPLITS, axis=-1)
    y_a, conv_new = causal_dwconv(g_c * xc, conv_buf, conv_w)
    y_a = g_b * y_a
    def heads(a):
        return a.astype(f32).reshape(B, T, MLSTM_HEADS, MLSTM_HD).transpose(0, 2, 1, 3)
    gates = (gates + b_gates).astype(f32)
    i_pre = gates[..., :MLSTM_HEADS].transpose(0, 2, 1)
    logf = jax.nn.log_sigmoid(gates[..., MLSTM_HEADS:]).transpose(0, 2, 1)
    h, C, n, m = mlstm_chunkwise(heads(q), heads(k) * (MLSTM_HD ** -0.5), heads(v), i_pre, logf, C0, n0, m0)
    h = h * lax.rsqrt(jnp.mean(h * h, axis=-1, keepdims=True) + EPS)
    h = h.transpose(0, 2, 1, 3).reshape(B, T, D_MLSTM) * mlstm_norm_w.astype(f32)
    y_b = (jax.nn.sigmoid(o.astype(f32)) * h).astype(xn.dtype)
    y = jnp.concatenate([y_a, y_b], axis=-1) @ w_out
    return y, conv_new, C, n, m


def memory_kv(mem, g, w_k, w_v):
    B = mem.shape[0]
    mn = rms_norm(mem, g)
    mk = (mn @ w_k).reshape(B, N_MEM, MEM_HEADS, MEM_HD)
    mv = (mn @ w_v).reshape(B, N_MEM, MEM_HEADS, MEM_HD)
    return mk, mv


def memory_attend(xn, mk, mv, w_q, w_o):
    B, T, _ = xn.shape
    q = (xn @ w_q).reshape(B, T, MEM_HEADS, MEM_HD)
    s = jnp.einsum('bthd,bmhd->bhtm', q, mk).astype(jnp.float32) * (MEM_HD ** -0.5)
    p = jax.nn.softmax(s, axis=-1).astype(xn.dtype)
    o = jnp.einsum('bhtm,bmhd->bthd', p, mv).reshape(B, T, D_MODEL)
    return o @ w_o


def conv_ffn(xn, ff_buf, w_up, ffn_conv_w, w_down):
    up, ff_new = causal_dwconv(xn @ w_up, ff_buf, ffn_conv_w)
    a, g = jnp.split(up, 2, axis=-1)
    return (jax.nn.gelu(g) * a) @ w_down, ff_new


def trunk_layer(x, mk, mv, conv_buf, C0, n0, m0, ff_buf, p):
    y, conv_new, C, n, m = token_mixer(rms_norm(x, p['norm_mix_pre']), conv_buf, C0, n0, m0,
                                       p['w_in'], p['b_gates'], p['conv_w'], p['mlstm_norm_w'], p['w_out'])
    x = x + rms_norm(y, p['norm_mix_post'])
    y = memory_attend(rms_norm(x, p['norm_mem_pre']), mk, mv, p['w_mq'], p['w_mo'])
    x = x + rms_norm(y, p['norm_mem_post'])
    y, ff_new = conv_ffn(rms_norm(x, p['norm_ffn_pre']), ff_buf, p['w_up'], p['ffn_conv_w'], p['w_down'])
    x = x + rms_norm(y, p['norm_ffn_post'])
    return x, conv_new, C, n, m, ff_new


def setup_inputs(seed: int = 0) -> dict:
    key = jax.random.key(seed)
    ks = jax.random.split(key, 40)
    f32 = jnp.float32

    def nrm(k, shape, s):
        return jax.random.normal(k, shape, f32) * s

    def gain(k, shape):
        return 1.0 + 0.05 * jax.random.normal(k, shape, f32)

    b_i = 0.1 * jax.random.normal(ks[0], (DEPTH, MLSTM_HEADS), f32)
    b_f = jnp.linspace(3.0, 6.0, MLSTM_HEADS, dtype=f32)[None, :] + 0.1 * jax.random.normal(ks[1], (DEPTH, MLSTM_HEADS), f32)
    return {
        'x_prompt': nrm(ks[2], (BATCH, SEQ, D_MODEL), 1.0),
        'x_sample': nrm(ks[3], (DEC_BATCH, DEC_SEQ, D_MODEL), 1.0),
        'mem_prompt': nrm(ks[4], (BATCH, N_MEM, D_MODEL), 1.0),
        'cache_mem_k': nrm(ks[5], (DEPTH, DEC_BATCH, N_MEM, MEM_HEADS, MEM_HD), 1.0),
        'cache_mem_v': nrm(ks[6], (DEPTH, DEC_BATCH, N_MEM, MEM_HEADS, MEM_HD), 1.0),
        'state_conv': nrm(ks[7], (DEPTH, DEC_BATCH, CONV_W - 1, D_CONV), 1.0),
        'state_mlstm_C': nrm(ks[8], (DEPTH, DEC_BATCH, MLSTM_HEADS, MLSTM_HD, MLSTM_HD), 0.1),
        'state_mlstm_n': nrm(ks[9], (DEPTH, DEC_BATCH, MLSTM_HEADS, MLSTM_HD), 0.5),
        'state_mlstm_m': nrm(ks[10], (DEPTH, DEC_BATCH, MLSTM_HEADS), 0.5),
        'state_ffn_conv': nrm(ks[11], (DEPTH, DEC_BATCH, FF_CONV_W - 1, 2 * D_FF), 1.0),
        'norm_mix_pre': gain(ks[12], (DEPTH, D_MODEL)),
        'w_in': nrm(ks[13], (DEPTH, D_MODEL, D_IN), D_MODEL ** -0.5),
        'b_gates': jnp.concatenate([b_i, b_f], axis=-1),
        'conv_w': nrm(ks[14], (DEPTH, CONV_W, D_CONV), CONV_W ** -0.5),
        'mlstm_norm_w': gain(ks[15], (DEPTH, D_MLSTM)),
        'w_out': nrm(ks[16], (DEPTH, D_MIX, D_MODEL), D_MIX ** -0.5),
        'norm_mix_post': gain(ks[17], (DEPTH, D_MODEL)),
        'norm_mem_pre': gain(ks[18], (DEPTH, D_MODEL)),
        'norm_mem_kv': gain(ks[19], (DEPTH, D_MODEL)),
        'w_mq': nrm(ks[20], (DEPTH, D_MODEL, D_MODEL), D_MODEL ** -0.5),
        'w_mk': nrm(ks[21], (DEPTH, D_MODEL, D_MODEL), D_MODEL ** -0.5),
        'w_mv': nrm(ks[22], (DEPTH, D_MODEL, D_MODEL), D_MODEL ** -0.5),
        'w_mo': nrm(ks[23], (DEPTH, D_MODEL, D_MODEL), D_MODEL ** -0.5),
        'norm_mem_post': gain(ks[24], (DEPTH, D_MODEL)),
        'norm_ffn_pre': gain(ks[25], (DEPTH, D_MODEL)),
        'w_up': nrm(ks[26], (DEPTH, D_MODEL, 2 * D_FF), D_MODEL ** -0.5),
        'ffn_conv_w': nrm(ks[27], (DEPTH, FF_CONV_W, 2 * D_FF), FF_CONV_W ** -0.5),
        'w_down': nrm(ks[28], (DEPTH, D_FF, D_MODEL), D_FF ** -0.5),
        'norm_ffn_post': gain(ks[29], (DEPTH, D_MODEL)),
    }


def reference(x_prompt, x_sample, mem_prompt, cache_mem_k, cache_mem_v, state_conv, state_mlstm_C,
              state_mlstm_n, state_mlstm_m, state_ffn_conv,
              norm_mix_pre, w_in, b_gates, conv_w, mlstm_norm_w, w_out, norm_mix_post,
              norm_mem_pre, norm_mem_kv, w_mq, w_mk, w_mv, w_mo, norm_mem_post,
              norm_ffn_pre, w_up, ffn_conv_w, w_down, norm_ffn_post):
    f32 = jnp.float32
    xp, xs = x_prompt, x_sample
    B = xp.shape[0]
    mk_p_all, mv_p_all = [], []
    conv_p_all, conv_s_all = [], []
    C_p_all, C_s_all, n_p_all, n_s_all, m_p_all, m_s_all = [], [], [], [], [], []
    ff_p_all, ff_s_all = [], []
    for l in range(DEPTH):
        p = {'norm_mix_pre': norm_mix_pre[l], 'w_in': w_in[l], 'b_gates': b_gates[l], 'conv_w': conv_w[l],
             'mlstm_norm_w': mlstm_norm_w[l], 'w_out': w_out[l], 'norm_mix_post': norm_mix_post[l],
             'norm_mem_pre': norm_mem_pre[l], 'w_mq': w_mq[l], 'w_mo': w_mo[l], 'norm_mem_post': norm_mem_post[l],
             'norm_ffn_pre': norm_ffn_pre[l], 'w_up': w_up[l], 'ffn_conv_w': ffn_conv_w[l], 'w_down': w_down[l],
             'norm_ffn_post': norm_ffn_post[l]}
        mk_p, mv_p = memory_kv(mem_prompt, norm_mem_kv[l], w_mk[l], w_mv[l])
        xp, conv_p, C_p, n_p, m_p, ff_p = trunk_layer(
            xp, mk_p, mv_p,
            jnp.zeros((B, CONV_W - 1, D_CONV), xp.dtype),
            jnp.zeros((B, MLSTM_HEADS, MLSTM_HD, MLSTM_HD), f32),
            jnp.zeros((B, MLSTM_HEADS, MLSTM_HD), f32),
            jnp.zeros((B, MLSTM_HEADS), f32),
            jnp.zeros((B, FF_CONV_W - 1, 2 * D_FF), xp.dtype), p)
        xs, conv_s, C_s, n_s, m_s, ff_s = trunk_layer(
            xs, cache_mem_k[l], cache_mem_v[l], state_conv[l],
            state_mlstm_C[l].astype(f32), state_mlstm_n[l].astype(f32), state_mlstm_m[l].astype(f32),
            state_ffn_conv[l], p)
        mk_p_all.append(mk_p); mv_p_all.append(mv_p)
        conv_p_all.append(conv_p); conv_s_all.append(conv_s)
        C_p_all.append(C_p); C_s_all.append(C_s)
        n_p_all.append(n_p); n_s_all.append(n_s)
        m_p_all.append(m_p); m_s_all.append(m_s)
        ff_p_all.append(ff_p); ff_s_all.append(ff_s)
    st = jnp.stack
    return (xp, xs, st(mk_p_all), st(mv_p_all), st(conv_p_all), st(conv_s_all),
            st(C_p_all), st(C_s_all), st(n_p_all), st(n_s_all), st(m_p_all), st(m_s_all),
            st(ff_p_all), st(ff_s_all))
```

```cpp
#include <hip/hip_runtime.h>
#include <hip/hip_cooperative_groups.h>
#include <cstdio>
#include <cstdint>
namespace cg = cooperative_groups;

#define LAS __attribute__((address_space(3)))
typedef unsigned short bf16_t;
typedef short bf16x8 __attribute__((ext_vector_type(8)));
typedef float f32x4 __attribute__((ext_vector_type(4)));
typedef unsigned u32x4 __attribute__((ext_vector_type(4)));
typedef unsigned u32x2 __attribute__((ext_vector_type(2)));

constexpr int DM = 1024, MP = 32768, MROWS = 33792, NTM = 132, MPADR = MROWS + 256;
constexpr int NCH = 528, NITEM = 2112;
constexpr int DIN = 3592, INW = 3072, DFF = 2816, DUP = 5632;
constexpr float EPS = 1e-6f;
constexpr float KSCALE = 0.08838834764831845f;

constexpr size_t O_Y = 0, O_MK = (size_t)MROWS * 1024, O_MV = O_MK + 1048576, O_CONVP = O_MV + 1048576, O_CONVS = O_CONVP + 4096,
                 O_CP = O_CONVS + 32768, O_CS = O_CP + 262144, O_NP = O_CS + 2097152, O_NS = O_NP + 2048, O_MPO = O_NS + 16384, O_MSO = O_MPO + 16,
                 O_FFP = O_MSO + 128, O_FFS = O_FFP + 45056, O_END = O_FFS + 360448;
static_assert(O_END == 39520400, "output size");

constexpr size_t U1 = (size_t)MPADR * 1024 * 2;
constexpr size_t WS_CTL = 0;
constexpr size_t WS_AA = 1u << 20;
constexpr size_t WS_BC = WS_AA + (size_t)MROWS * 16;
constexpr size_t WS_CHG = WS_BC + (size_t)MROWS * 16;
constexpr size_t WS_CHA = WS_CHG + 8448;
constexpr size_t WS_MIN = WS_CHA + 8448;
constexpr size_t WS_MOUT = WS_MIN + 8448;
constexpr size_t WS_WC = WS_MOUT + 8448;
constexpr size_t WS_NST = WS_WC + 8448;
constexpr size_t WS_NU = WS_NST + (size_t)NITEM * 512;
constexpr size_t WS_W = 6u << 20;
constexpr size_t W_IN = 0, W_OUT = W_IN + (size_t)3584 * 1024 * 2, W_MQ = W_OUT + 2097152, W_MO = W_MQ + 2097152, W_UP = W_MO + 2097152,
                 W_DOWN = W_UP + (size_t)5632 * 1024 * 2, W_END = W_DOWN + (size_t)1024 * 2816 * 2;
constexpr size_t WS_MKP = WS_W + W_END;
constexpr size_t WS_MVP = WS_MKP + 2097152;
constexpr size_t WS_MKS = WS_MVP + 2097152;
constexpr size_t WS_MVS = WS_MKS + 8388608;
constexpr size_t WS_R0 = ((WS_MVS + 8388608 + 4095) / 4096) * 4096;
constexpr size_t WS_R1 = WS_R0 + U1;
constexpr size_t WS_END = WS_R1 + U1 * 11 / 2;
static_assert(WS_NU + (size_t)NITEM * 512 <= WS_W, "small region");
static_assert(WS_END <= 536870912ull, "workspace");
constexpr size_t A_IN = WS_R1, A_Y = WS_R1 + 3 * U1, A_YF = WS_R1, A_Q2 = WS_R1 + 2 * U1, A_P = WS_R1 + 3 * U1, A_O2 = WS_R1 + 4 * U1,
                 A_UP = WS_R1, A_ACT = WS_R1 + U1 * 11 / 4, A_WKV = WS_R1, A_MN = WS_R1 + (size_t)2 * 2048 * 1024 * 2;

constexpr size_t A_UC = WS_R0;
constexpr int LDS_BYTES = 147456, XL_OFF = 131072;
#ifndef STOP_AT
#define STOP_AT 99
#endif

struct Params { const float* in[29]; float* out; unsigned char* ws; };
typedef const __attribute__((address_space(4))) Params* KP;
__device__ __forceinline__ KP kp_new() { KP p = (KP)__builtin_amdgcn_kernarg_segment_ptr(); asm volatile("" : "+s"(p)); return p; }

__device__ __forceinline__ unsigned f2bf(float f) { return (unsigned)__builtin_bit_cast(unsigned short, (__bf16)f); }
__device__ __forceinline__ float bf2f(unsigned h) { return __uint_as_float(h << 16); }
__device__ __forceinline__ float bflo(unsigned w) { return __uint_as_float(w << 16); }
__device__ __forceinline__ float bfhi(unsigned w) { return __uint_as_float(w & 0xffff0000u); }
typedef float f32x2v __attribute__((ext_vector_type(2)));
typedef __bf16 bf16x2v __attribute__((ext_vector_type(2)));
__device__ __forceinline__ unsigned pk2(float lo, float hi) { const f32x2v v = {lo, hi}; return __builtin_bit_cast(unsigned, __builtin_convertvector(v, bf16x2v)); }
__device__ __forceinline__ float wave_sum(float v) {
#pragma unroll
    for (int o = 1; o < 64; o <<= 1) v += __shfl_xor(v, o);
    return v;
}
__device__ __forceinline__ float wave_max(float v) {
#pragma unroll
    for (int o = 1; o < 64; o <<= 1) v = fmaxf(v, __shfl_xor(v, o));
    return v;
}
__device__ __forceinline__ void unpack8(const u32x4 w, float (&f)[8]) {
    f[0] = bflo(w.x); f[1] = bfhi(w.x); f[2] = bflo(w.y); f[3] = bfhi(w.y); f[4] = bflo(w.z); f[5] = bfhi(w.z); f[6] = bflo(w.w); f[7] = bfhi(w.w);
}
__device__ __forceinline__ float gelu_tanh(float x) {
    const float z = 0.7978845608028654f * (x + 0.044715f * x * x * x);
    const float e = __expf(2.f * z);
    const float t = 1.f - 2.f / (e + 1.f);
    return 0.5f * x * (1.f + t);
}
#define LDS_WAIT() asm volatile("s_waitcnt lgkmcnt(0)" ::: "memory")
__device__ __forceinline__ int lane_id_fresh() { int l; asm volatile("v_mbcnt_lo_u32_b32 %0, -1, 0\n\tv_mbcnt_hi_u32_b32 %0, -1, %0" : "=v"(l)); return l; }

namespace pg8 {
constexpr int BM = 256, BK = 64, HALF = 128, HTB = HALF * BK * 2, STAGE_BYTES = 8 * HTB;
__host__ __device__ __forceinline__ int lds_byte(int r, int c) { const int st = (r >> 4) * 2 + (c >> 5), rr = r & 15, cc = c & 31, ob = rr * 64 + cc * 2; return st * 1024 + (ob ^ (((ob >> 9) & 1) << 5)); }
__host__ __device__ __forceinline__ void stage_rc(int b, int& R, int& C) { const int st = b / 1024, sb = b % 1024, swz = sb ^ (((sb >> 9) & 1) << 5); R = (st >> 1) * 16 + swz / 64; C = (st & 1) * 32 + (swz % 64) / 2; }
__host__ __device__ __forceinline__ int perm32(int rho) { const int n = rho >> 4, i = rho & 15; return 8 * (i >> 2) + 4 * n + (i & 3); }

struct Unit { const char* a; const char* b; int pm, pn, row0, aux; };

template <class Epi, class Sched, bool ALIGN_EPI>
__device__ __forceinline__ void gemm_phase(LAS unsigned char* lds, LAS unsigned char* xl, const int wid, const int K, const int lda, const int ldb, const Sched& S, const Epi& E) {
    const int lane = lane_id_fresh(), tid = wid * 64 + lane;
    const int wr = wid >> 2, wc = wid & 3, fr = lane & 15, fq = lane >> 4;
    int nt = K / BK; asm volatile("" : "+s"(nt));
    unsigned voffA[2], voffB[2];
#pragma unroll
    for (int i = 0; i < 2; ++i) { int R, C; stage_rc(tid * 16 + i * 8192, R, C); const int Rb = Epi::PERM ? ((R & ~31) + perm32(R & 31)) : R;
        voffA[i] = (unsigned)(R * lda + C) * 2u; voffB[i] = (unsigned)(Rb * ldb + C) * 2u; }
    const size_t kstep = (size_t)(BK * 2);
    const size_t hA = (size_t)HALF * lda * 2, hB = (size_t)HALF * ldb * 2;
    const unsigned ldsw = (unsigned)wid * 1024u;
    const int aoff = lds_byte(wr * 64 + fr, fq * 8), boff = lds_byte(wc * 32 + fr, fq * 8);
#define PG8_SA(b, h) (((b) * 2 + (h)) * HTB)
#define PG8_SB(b, h) ((4 + (b) * 2 + (h)) * HTB)
#define PG8_STAGE(bufoff, gbase, voff) do { _Pragma("unroll") for (int _i = 0; _i < 2; ++_i) \
        __builtin_amdgcn_global_load_lds((const unsigned*)((const char*)(gbase) + (voff)[_i]), (LAS unsigned*)(lds + (bufoff) + ldsw + _i * 8192), 16, 0, 0); } while (0)
#define PG8_LDA(dst, b, h) do { _Pragma("unroll") for (int m = 0; m < 4; ++m) _Pragma("unroll") for (int k = 0; k < 2; ++k) dst[m][k] = *(const LAS bf16x8*)(lds + PG8_SA(b, h) + aoff + m * 2048 + k * 1024); } while (0)
#define PG8_LDB(dst, b, h) do { _Pragma("unroll") for (int n = 0; n < 2; ++n) _Pragma("unroll") for (int k = 0; k < 2; ++k) dst[n][k] = *(const LAS bf16x8*)(lds + PG8_SB(b, h) + boff + n * 2048 + k * 1024); } while (0)
#define PG8_MMA(ai, bj, At, Bt) do { __builtin_amdgcn_s_setprio(1); _Pragma("unroll") for (int m = 0; m < 4; ++m) _Pragma("unroll") for (int n = 0; n < 2; ++n) _Pragma("unroll") for (int k = 0; k < 2; ++k) \
        acc[ai][bj][m][n] = __builtin_amdgcn_mfma_f32_16x16x32_bf16(Bt[n][k], At[m][k], acc[ai][bj][m][n], 0, 0, 0); __builtin_amdgcn_s_setprio(0); } while (0)
#define PG8_WAIT_V(n) asm volatile("s_waitcnt vmcnt(" #n ")" ::: "memory")
#define PG8_WAIT_L(n) asm volatile("s_waitcnt lgkmcnt(" #n ")" ::: "memory")
#define PG8_BAR __builtin_amdgcn_s_barrier()
#define PG8_SCHED __builtin_amdgcn_sched_barrier(0)
    Unit cur, nxt; int ui = 0;
    if (!S.next(0, cur)) return;
    f32x4 acc[2][2][4][2];
#pragma unroll
    for (int a = 0; a < 2; ++a)
#pragma unroll
        for (int b = 0; b < 2; ++b)
#pragma unroll
            for (int m = 0; m < 4; ++m)
#pragma unroll
                for (int n = 0; n < 2; ++n) acc[a][b][m][n] = (f32x4){0.f, 0.f, 0.f, 0.f};
    bf16x8 At[4][2], B0[2][2], B1[2][2];
    const char* cA = cur.a; const char* cB = cur.b;
    PG8_STAGE(PG8_SB(0, 0), cB, voffB); PG8_STAGE(PG8_SB(0, 1), cB + hB, voffB); PG8_STAGE(PG8_SA(0, 0), cA, voffA); PG8_STAGE(PG8_SA(0, 1), cA + hA, voffA);
    if (wr == 1) PG8_BAR;
    PG8_WAIT_V(2); PG8_BAR;
    PG8_STAGE(PG8_SB(1, 0), cB + kstep, voffB); PG8_STAGE(PG8_SA(1, 0), cA + kstep, voffA); PG8_STAGE(PG8_SB(1, 1), cB + hB + kstep, voffB);
    PG8_WAIT_V(6); PG8_BAR;
    for (;;) {
        const bool has_next = S.next(ui + 1, nxt);
        const char* nA = has_next ? nxt.a : cA; const char* nB = has_next ? nxt.b : cB;
        for (int t = 0; t < nt; t += 2) {
            const bool last = (t == nt - 2);
            const char* a1 = cA + (size_t)(t + 1) * kstep;
            const char* a2 = last ? nA : cA + (size_t)(t + 2) * kstep; const char* b2 = last ? nB : cB + (size_t)(t + 2) * kstep;
            const char* a3 = a2 + kstep; const char* b3 = b2 + kstep;
            PG8_LDB(B0, 0, 0); PG8_LDB(B1, 0, 1); PG8_SCHED; PG8_LDA(At, 0, 0); PG8_STAGE(PG8_SA(1, 1), a1 + hA, voffA);
            PG8_WAIT_V(8); PG8_WAIT_L(0); PG8_BAR; PG8_MMA(0, 0, At, B0); PG8_MMA(0, 1, At, B1); PG8_BAR; PG8_SCHED;
            PG8_LDA(At, 0, 1); PG8_STAGE(PG8_SB(0, 0), b2, voffB); PG8_STAGE(PG8_SB(0, 1), b2 + hB, voffB); PG8_STAGE(PG8_SA(0, 0), a2, voffA);
            PG8_WAIT_V(8); PG8_WAIT_L(0); PG8_BAR; PG8_MMA(1, 0, At, B0); PG8_MMA(1, 1, At, B1); PG8_BAR; PG8_SCHED;
            PG8_LDB(B0, 1, 0); PG8_LDB(B1, 1, 1); PG8_SCHED; PG8_LDA(At, 1, 0); PG8_STAGE(PG8_SA(0, 1), a2 + hA, voffA);
            PG8_WAIT_V(8); PG8_WAIT_L(0); PG8_BAR; PG8_MMA(0, 0, At, B0); PG8_MMA(0, 1, At, B1); PG8_BAR; PG8_SCHED;
            PG8_LDA(At, 1, 1); PG8_STAGE(PG8_SB(1, 0), b3, voffB); PG8_STAGE(PG8_SB(1, 1), b3 + hB, voffB); PG8_STAGE(PG8_SA(1, 0), a3, voffA);
            PG8_WAIT_V(8); PG8_WAIT_L(0); PG8_BAR; PG8_MMA(1, 0, At, B0); PG8_MMA(1, 1, At, B1); PG8_BAR; PG8_SCHED;
        }
        if constexpr (ALIGN_EPI) { if (wr == 0) PG8_BAR; }
        E(acc, cur, wr, wc, fr, fq, xl, wid, lane);
        if (!has_next) break;
#pragma unroll
        for (int a = 0; a < 2; ++a)
#pragma unroll
            for (int b = 0; b < 2; ++b)
#pragma unroll
                for (int m = 0; m < 4; ++m)
#pragma unroll
                    for (int n = 0; n < 2; ++n) acc[a][b][m][n] = (f32x4){0.f, 0.f, 0.f, 0.f};
        cur = nxt; cA = nA; cB = nB; ++ui;
        if constexpr (ALIGN_EPI) { if (wr == 1) PG8_BAR; }
    }
    PG8_WAIT_V(0);
    if constexpr (!ALIGN_EPI) { if (wr == 0) PG8_BAR; }
    PG8_BAR;
#undef PG8_SA
#undef PG8_SB
#undef PG8_STAGE
#undef PG8_LDA
#undef PG8_LDB
#undef PG8_MMA
#undef PG8_WAIT_V
#undef PG8_WAIT_L
#undef PG8_BAR
#undef PG8_SCHED
}

struct TileOrder {
    const char* A; const char* B; size_t at, bt; int nM, nN, nwg, G, c;
    __device__ __forceinline__ void init(const void* A_, size_t at_, const void* B_, size_t bt_, int nM_, int nN_, int G_, int c_) { A = (const char*)A_; B = (const char*)B_; at = at_; bt = bt_; nM = nM_; nN = nN_; nwg = nM * nN; G = G_; c = c_; }
    __device__ __forceinline__ bool next(int i, Unit& u) const {
        const long L = (long)i * G + c; if (L >= nwg) return false;
        int wgid = (int)L; { const int q = nwg / 8, r = nwg % 8, xcd = wgid % 8, off = wgid / 8; wgid = (xcd < r ? xcd * (q + 1) : r * (q + 1) + (xcd - r) * q) + off; }
        const int nig = 8 * nN, gid = wgid / nig, fm = gid * 8, gsz = (nM - fm) < 8 ? (nM - fm) : 8;
        u.pm = fm + ((wgid % nig) % gsz); u.pn = (wgid % nig) / gsz; u.row0 = u.pm * 256; u.aux = 256;
        u.a = A + (size_t)u.pm * at; u.b = B + (size_t)u.pn * bt; return true;
    }
};
struct MemKvOrder {
    const char* MN; const char* WKV; int G, c;
    __device__ __forceinline__ bool next(int i, Unit& u) const {
        const int L = i * G + c; if (L >= 32) return false;
        const int l = L >> 4, r = L & 15; u.pm = r >> 3; u.pn = r & 7; u.aux = l; u.row0 = 0;
        u.a = MN + (size_t)(l * 512 + u.pm * 256) * 2048; u.b = WKV + (size_t)(l * 2048 + u.pn * 256) * 2048; return true;
    }
};
struct AttnOrder {
    const char* A; const char* BP; const char* BS; size_t bstride_batch, bstride_head; int G, c;
    __device__ __forceinline__ bool next(int i, Unit& u) const {
        const int L = i * G + c; if (L >= 576) return false;
        if (L < 512) { const int pm = L >> 2, h = L & 3; u.pm = pm; u.pn = h; u.row0 = pm * 256; u.aux = 256;
            u.a = A + ((size_t)u.row0 * 1024 + h * 256) * 2; u.b = BP + (size_t)(pm >> 6) * bstride_batch + (size_t)h * bstride_head; }
        else { const int r = L - 512, b = r >> 2, h = r & 3; u.pm = 128 + (b >> 2); u.pn = h; u.row0 = MP + 64 * b; u.aux = 64;
            u.a = A + ((size_t)u.row0 * 1024 + h * 256) * 2; u.b = BS + (size_t)b * bstride_batch + (size_t)h * bstride_head; }
        return true;
    }
};

typedef f32x4 Acc[2][2][4][2];
struct EpiIn {
    static constexpr bool PERM = true;
    bf16_t* IN; float* convp; float* convs;
    __device__ __forceinline__ void operator()(Acc& acc, const Unit& u, int wr, int wc, int fr, int fq, LAS unsigned char*, int, int) const {
        asm volatile("" : "+v"(fr), "+v"(fq));
        const int lr0 = wr * 64 + fr;
        if (u.pn < 4) {
            const int col = 128 * u.pn + 32 * wc + 8 * fq;
#pragma unroll
            for (int ai = 0; ai < 2; ++ai)
#pragma unroll
                for (int m = 0; m < 4; ++m) {
                    const int lr = lr0 + ai * 128 + m * 16; const size_t row = (size_t)u.row0 + lr;
                    const f32x4 v0 = acc[ai][0][m][0] * acc[ai][1][m][0], v1 = acc[ai][0][m][1] * acc[ai][1][m][1];
                    u32x4 w; w.x = pk2(v0[0], v0[1]); w.y = pk2(v0[2], v0[3]); w.z = pk2(v1[0], v1[1]); w.w = pk2(v1[2], v1[3]);
                    *(u32x4*)(IN + row * INW + col) = w;
                    if (m == 3 && fr >= 14) {
                        float* dst = nullptr;
                        if (u.pm >= 128) { const int b = 4 * (u.pm - 128) + (lr >> 6); dst = convs + ((size_t)b * 2 + (fr - 14)) * 512 + col; }
                        else if ((u.pm & 63) == 63 && ai == 1 && wr == 1) { dst = convp + ((size_t)(u.pm >> 6) * 2 + (fr - 14)) * 512 + col; }
                        if (dst) { *(f32x4*)dst = v0; *(f32x4*)(dst + 4) = v1; }
                    }
                }
        } else {
            const int col = 512 + 256 * (u.pn - 4) + 32 * wc + 8 * fq;
#pragma unroll
            for (int ai = 0; ai < 2; ++ai)
#pragma unroll
                for (int m = 0; m < 4; ++m) {
                    const size_t row = (size_t)u.row0 + lr0 + ai * 128 + m * 16;
#pragma unroll
                    for (int bj = 0; bj < 2; ++bj) { const f32x4 v0 = acc[ai][bj][m][0], v1 = acc[ai][bj][m][1];
                        u32x4 w; w.x = pk2(v0[0], v0[1]); w.y = pk2(v0[2], v0[3]); w.z = pk2(v1[0], v1[1]); w.w = pk2(v1[2], v1[3]);
                        *(u32x4*)(IN + row * INW + col + bj * 128) = w; }
                }
        }
    }
};
struct EpiF32 {
    static constexpr bool PERM = false;
    float* O;
    __device__ __forceinline__ void operator()(Acc& acc, const Unit& u, int wr, int wc, int fr, int fq, LAS unsigned char*, int, int) const {
        asm volatile("" : "+v"(fr), "+v"(fq));
        const int col = u.pn * 256 + wc * 32 + 4 * fq;
#pragma unroll
        for (int ai = 0; ai < 2; ++ai)
#pragma unroll
            for (int m = 0; m < 4; ++m) { float* rp = O + ((size_t)u.row0 + wr * 64 + fr + ai * 128 + m * 16) * 1024 + col;
#pragma unroll
                for (int bj = 0; bj < 2; ++bj)
#pragma unroll
                    for (int n = 0; n < 2; ++n) *(f32x4*)(rp + bj * 128 + n * 16) = acc[ai][bj][m][n]; }
    }
};
struct EpiBf16 {
    static constexpr bool PERM = true;
    bf16_t* O; int ldc; float scale;
    __device__ __forceinline__ void operator()(Acc& acc, const Unit& u, int wr, int wc, int fr, int fq, LAS unsigned char*, int, int) const {
        asm volatile("" : "+v"(fr), "+v"(fq));
        const int col = u.pn * 256 + wc * 32 + 8 * fq;
#pragma unroll
        for (int ai = 0; ai < 2; ++ai)
#pragma unroll
            for (int m = 0; m < 4; ++m) { const int lr = wr * 64 + fr + ai * 128 + m * 16;
                if (lr < u.aux) { bf16_t* rp = O + ((size_t)u.row0 + lr) * ldc + col;
#pragma unroll
                    for (int bj = 0; bj < 2; ++bj) { const f32x4 v0 = acc[ai][bj][m][0] * scale, v1 = acc[ai][bj][m][1] * scale;
                        u32x4 w; w.x = pk2(v0[0], v0[1]); w.y = pk2(v0[2], v0[3]); w.z = pk2(v1[0], v1[1]); w.w = pk2(v1[2], v1[3]);
                        *(u32x4*)(rp + bj * 128) = w; } } }
    }
};
struct EpiSoftmax {
    static constexpr bool PERM = true;
    bf16_t* O;
    __device__ __forceinline__ void operator()(Acc& acc, const Unit& u, int wr, int wc, int fr, int fq, LAS unsigned char* xl, int, int) const {
        asm volatile("" : "+v"(fr), "+v"(fq));
        LAS float* PM = (LAS float*)xl; LAS float* PS = (LAS float*)(xl + 4096);
#pragma unroll
        for (int ai = 0; ai < 2; ++ai)
#pragma unroll
            for (int m = 0; m < 4; ++m) { float v = -3.0e38f;
#pragma unroll
                for (int bj = 0; bj < 2; ++bj)
#pragma unroll
                    for (int n = 0; n < 2; ++n) { const f32x4 x = acc[ai][bj][m][n]; v = fmaxf(v, fmaxf(fmaxf(x[0], x[1]), fmaxf(x[2], x[3]))); }
                v = fmaxf(v, __shfl_xor(v, 16)); v = fmaxf(v, __shfl_xor(v, 32));
                if (fq == 0) PM[(ai * 128 + wr * 64 + m * 16 + fr) * 4 + wc] = v; }
        LDS_WAIT(); __builtin_amdgcn_s_barrier(); asm volatile("" ::: "memory");
#pragma unroll
        for (int ai = 0; ai < 2; ++ai)
#pragma unroll
            for (int m = 0; m < 4; ++m) { const int r = ai * 128 + wr * 64 + m * 16 + fr; const f32x4 p4 = *(const LAS f32x4*)(PM + r * 4);
                const float mx = fmaxf(fmaxf(p4[0], p4[1]), fmaxf(p4[2], p4[3])); float s = 0.f;
#pragma unroll
                for (int bj = 0; bj < 2; ++bj)
#pragma unroll
                    for (int n = 0; n < 2; ++n) { const f32x4 x = acc[ai][bj][m][n]; s += (__expf(x[0] - mx) + __expf(x[1] - mx)) + (__expf(x[2] - mx) + __expf(x[3] - mx)); }
                s += __shfl_xor(s, 16); s += __shfl_xor(s, 32);
                if (fq == 0) PS[r * 4 + wc] = s; asm volatile("" ::: "memory"); }
        LDS_WAIT(); __builtin_amdgcn_s_barrier(); asm volatile("" ::: "memory");
        asm volatile("" : "+v"(fr), "+v"(fq));
        const int col = u.pn * 256 + wc * 32 + 8 * fq;
#pragma unroll
        for (int ai = 0; ai < 2; ++ai)
#pragma unroll
            for (int m = 0; m < 4; ++m) { const int r = ai * 128 + wr * 64 + m * 16 + fr; const f32x4 s4 = *(const LAS f32x4*)(PS + r * 4); const f32x4 p4 = *(const LAS f32x4*)(PM + r * 4);
                const float mx = fmaxf(fmaxf(p4[0], p4[1]), fmaxf(p4[2], p4[3]));
                const float inv = 1.f / ((s4[0] + s4[1]) + (s4[2] + s4[3]));
                if (r < u.aux) { bf16_t* rp = O + ((size_t)u.row0 + r) * 1024 + col;
#pragma unroll
                    for (int bj = 0; bj < 2; ++bj) { const f32x4 a0 = acc[ai][bj][m][0], a1 = acc[ai][bj][m][1];
                        u32x4 w; w.x = pk2(__expf(a0[0] - mx) * inv, __expf(a0[1] - mx) * inv); w.y = pk2(__expf(a0[2] - mx) * inv, __expf(a0[3] - mx) * inv);
                        w.z = pk2(__expf(a1[0] - mx) * inv, __expf(a1[1] - mx) * inv); w.w = pk2(__expf(a1[2] - mx) * inv, __expf(a1[3] - mx) * inv);
                        *(u32x4*)(rp + bj * 128) = w; } } asm volatile("" ::: "memory"); }
    }
};
struct EpiUp {
    static constexpr bool PERM = true;
    bf16_t* UP; int grp; float* ffp; float* ffs;
    __device__ __forceinline__ void operator()(Acc& acc, const Unit& u, int wr, int wc, int fr, int fq, LAS unsigned char*, int, int) const {
        asm volatile("" : "+v"(fr), "+v"(fq));
        const int wcol = 32 * wc + 8 * fq, col = u.pn * 256 + wcol, j = 11 * grp + u.pn;
#pragma unroll
        for (int ai = 0; ai < 2; ++ai)
#pragma unroll
            for (int m = 0; m < 4; ++m) { const int lr = wr * 64 + fr + ai * 128 + m * 16; bf16_t* rp = UP + ((size_t)u.row0 + lr) * DFF + col;
                float* dst = nullptr;
                if (m == 3 && fr >= 14) {
                    if (u.pm >= 128) { const int b = 4 * (u.pm - 128) + (lr >> 6); dst = ffs + ((size_t)b * 2 + (fr - 14)) * DUP; }
                    else if ((u.pm & 63) == 63 && ai == 1 && wr == 1) dst = ffp + ((size_t)(u.pm >> 6) * 2 + (fr - 14)) * DUP;
                }
#pragma unroll
                for (int bj = 0; bj < 2; ++bj) { const f32x4 v0 = acc[ai][bj][m][0], v1 = acc[ai][bj][m][1];
                    u32x4 w; w.x = pk2(v0[0], v0[1]); w.y = pk2(v0[2], v0[3]); w.z = pk2(v1[0], v1[1]); w.w = pk2(v1[2], v1[3]);
                    *(u32x4*)(rp + bj * 128) = w;
                    if (dst) { float* d2 = dst + bj * DFF + 128 * j + wcol; *(f32x4*)d2 = v0; *(f32x4*)(d2 + 4) = v1; } } }
    }
};
struct EpiMemKv {
    static constexpr bool PERM = false;
    float* outk; float* outv; bf16_t* mk; bf16_t* mvt;
    __device__ __forceinline__ void operator()(Acc& acc, const Unit& u, int wr, int wc, int fr, int fq, LAS unsigned char*, int, int) const {
        asm volatile("" : "+v"(fr), "+v"(fq));
        const int l = u.aux, b = u.pm, isv = u.pn >> 2, h = u.pn & 3;
        float* ob = (isv ? outv : outk) + ((size_t)(l * 2 + b) * 256) * 1024 + h * 256;
        bf16_t* kb = mk + ((size_t)(l * 2 + b) * 256) * 1024 + h * 256;
        bf16_t* vb = mvt + ((size_t)(l * 2 + b) * 4 + h) * 65536;
#pragma unroll
        for (int ai = 0; ai < 2; ++ai)
#pragma unroll
            for (int m = 0; m < 4; ++m) { const int r = wr * 64 + fr + ai * 128 + m * 16;
#pragma unroll
                for (int bj = 0; bj < 2; ++bj)
#pragma unroll
                    for (int n = 0; n < 2; ++n) { const int c = bj * 128 + wc * 32 + n * 16 + 4 * fq; const f32x4 v = acc[ai][bj][m][n];
                        *(f32x4*)(ob + (size_t)r * 1024 + c) = v;
                        if (!isv) { u32x2 w; w.x = pk2(v[0], v[1]); w.y = pk2(v[2], v[3]); *(u32x2*)(kb + (size_t)r * 1024 + c) = w; }
                        else {
#pragma unroll
                            for (int e = 0; e < 4; ++e) vb[(size_t)(c + e) * 256 + r] = (bf16_t)f2bf(v[e]); } } }
    }
};
}

#define XB_TMO      128
#define XB_XCNT(j)  (256  + 64 * (j))
#define XB_XSUB(j)  (1280 + 64 * (j))
#define XB_XGEN(j)  (2304 + 64 * (j))
#define XB_TOP      3328
#define XB_TOPGEN   3392
#define XCD_BAR_WORDS 3456
#define XB_SPIN_CAP (1u << 20)
__device__ __forceinline__ unsigned xb_ld(unsigned* p)              { return __hip_atomic_load(p, __ATOMIC_RELAXED, __HIP_MEMORY_SCOPE_AGENT); }
__device__ __forceinline__ unsigned xb_add(unsigned* p, unsigned v) { return __hip_atomic_fetch_add(p, v, __ATOMIC_RELAXED, __HIP_MEMORY_SCOPE_AGENT); }
__device__ __forceinline__ unsigned xb_xcc_id() { return (unsigned)__builtin_amdgcn_s_getreg((3 << 11) | 20) & 0xFu; }
#define XB_SPIN(cond, bar) do { unsigned _sp = 0; while (cond) { __builtin_amdgcn_s_sleep(1); \
    if ((++_sp & 255u) == 0u) { if (xb_ld(&(bar)[XB_TMO])) break; if (_sp > XB_SPIN_CAP) { atomicAdd(&(bar)[XB_TMO], 1u); break; } } } } while (0)
struct XcdBarrier { unsigned* bar; unsigned x; volatile LAS unsigned* st; };
__device__ __forceinline__ XcdBarrier xcd_barrier_post(unsigned* bar, volatile LAS unsigned* st, int wid) {
    XcdBarrier b; b.bar = bar; b.x = xb_xcc_id(); b.st = st;
    if (wid == 0 && lane_id_fresh() == 0) (void)xb_add(&bar[XB_XCNT(b.x)], 1u);
    return b;
}
__device__ __forceinline__ void xcd_barrier_complete(unsigned* bar, unsigned x, unsigned& nloc, unsigned& nx) {
    const unsigned G = gridDim.x * gridDim.y * gridDim.z;
    unsigned sum, cnt, mine, sp = 0u;
    for (;;) {
        sum = 0u; cnt = 0u; mine = 0u;
#pragma unroll
        for (unsigned j = 0; j < 16; ++j) { const unsigned c = xb_ld(&bar[XB_XCNT(j)]); sum += c; cnt += (c > 0u) ? 1u : 0u; mine = (j == x) ? c : mine; }
        if (sum == G) break;
        __builtin_amdgcn_s_sleep(1);
        if ((++sp & 255u) == 0u) { if (xb_ld(&bar[XB_TMO])) break; if (sp > XB_SPIN_CAP) { atomicAdd(&bar[XB_TMO], 1u); break; } }
    }
    nloc = mine > 0u ? mine : 1u; nx = cnt > 0u ? cnt : 1u;
}
__device__ __forceinline__ void xcd_barrier(const XcdBarrier& b, int wid) {
    asm volatile("s_waitcnt vmcnt(0)" ::: "memory");
    __syncthreads();
    if (wid == 0 && lane_id_fresh() == 0) {
        unsigned* bar = b.bar;
        __builtin_amdgcn_s_waitcnt(0);
        unsigned nloc = b.st[0], nx = b.st[1];
        if (nloc == 0u) { xcd_barrier_complete(bar, b.x, nloc, nx); b.st[0] = nloc; b.st[1] = nx; }
        const unsigned old = xb_add(&bar[XB_XSUB(b.x)], 1u);
        const unsigned gen = old / nloc;
        if (old + 1u == (gen + 1u) * nloc) {
            __builtin_amdgcn_fence(__ATOMIC_RELEASE, "agent");
            asm volatile("s_waitcnt vmcnt(0)" ::: "memory");
            const unsigned og = xb_add(&bar[XB_TOP], 1u);
            const unsigned tg = og / nx;
            if (og + 1u == (tg + 1u) * nx) xb_add(&bar[XB_TOPGEN], 1u);
            else XB_SPIN(xb_ld(&bar[XB_TOPGEN]) == tg, bar);
            __builtin_amdgcn_fence(__ATOMIC_ACQUIRE, "agent");
            xb_add(&bar[XB_XGEN(b.x)], 1u);
            asm volatile("s_waitcnt vmcnt(0)" ::: "memory");
        } else {
            XB_SPIN(xb_ld(&bar[XB_XGEN(b.x)]) == gen, bar);
            __builtin_amdgcn_fence(__ATOMIC_ACQUIRE, "agent");
            asm volatile("s_waitcnt vmcnt(0)" ::: "memory");
        }
    }
    __syncthreads();
}

struct Ctx {
    LAS unsigned char* lds; int tid, lane, wid, G, bid;
};
__device__ __forceinline__ Ctx mkctx(const Ctx& c0) { Ctx c; c.lds = c0.lds; c.wid = c0.wid; c.lane = lane_id_fresh(); c.tid = c.wid * 64 + c.lane; c.G = c0.G; c.bid = c0.bid; return c; }
#define WSP(T, off) ((T*)(p->ws + (off)))

__device__ __forceinline__ void tr_item(const float* W, int ldw, int k0, int c0, bf16_t* WT, int ldt, int n0, LAS float* scr, int lane) {
#pragma unroll 8
    for (int i = 0; i < 32; ++i) { const int kk = 2 * i + (lane >> 5); scr[kk * 33 + (lane & 31)] = W[(size_t)(k0 + kk) * ldw + c0 + (lane & 31)]; }
    LDS_WAIT(); asm volatile("" ::: "memory");
    const int c = lane & 7;
#pragma unroll
    for (int j = 0; j < 4; ++j) { const int n = (lane >> 3) + 8 * j; const LAS float* s = scr + (8 * c) * 33 + n;
        u32x4 o; o.x = pk2(s[0], s[33]); o.y = pk2(s[2 * 33], s[3 * 33]); o.z = pk2(s[4 * 33], s[5 * 33]); o.w = pk2(s[6 * 33], s[7 * 33]);
        *(u32x4*)(WT + (size_t)(n0 + n) * ldt + k0 + 8 * c) = o; }
    LDS_WAIT(); asm volatile("" ::: "memory");
}
template <int MAP> __device__ __forceinline__ int srcmap(int n0) {
    if (MAP == 1) {
        if (n0 < 1024) { const int j = n0 >> 8, r = n0 & 255; return r < 128 ? 128 * j + r : 1024 + 128 * j + (r - 128); }
        if (n0 < 1536) return 512 + (n0 - 1024);
        return n0;
    }
    if (MAP == 2) { const int j = n0 >> 8, r = n0 & 255; return r < 128 ? 128 * j + r : DFF + 128 * j + (r - 128); }
    return n0;
}
template <int MAP> __device__ __forceinline__ void tr_matrix(const float* W, int K, int ldw, int N, bf16_t* WT, int& base, int gw, int ngw, LAS float* scr, int lane) {
    const int nb = N / 32, items = (K / 64) * nb;
    int first = (gw - base) % ngw; if (first < 0) first += ngw;
    for (int it = first; it < items; it += ngw) { const int kb = it / nb, n0 = (it % nb) * 32; tr_item(W, ldw, kb * 64, srcmap<MAP>(n0), WT, K, n0, scr, lane); }
    base += items;
}

__device__ __forceinline__ const float* xin_row(KP p, int row) { return row < MP ? p->in[0] + (size_t)row * 1024 : p->in[1] + (size_t)(row - MP) * 1024; }

__device__ __forceinline__ void phase_p0(KP p, const Ctx& c0) {
    const Ctx c = mkctx(c0);
    LAS float* scr = (LAS float*)(c.lds + c.wid * 8704);
    const int gw = c.bid * 8 + c.wid, ngw = c.G * 8;
    int base = 0;
    bf16_t* wkv = WSP(bf16_t, A_WKV);
    for (int l = 0; l < 2; ++l) {
        tr_matrix<0>(p->in[20] + (size_t)l * 1048576, 1024, 1024, 1024, wkv + (size_t)(l * 2048) * 1024, base, gw, ngw, scr, c.lane);
        tr_matrix<0>(p->in[21] + (size_t)l * 1048576, 1024, 1024, 1024, wkv + (size_t)(l * 2048 + 1024) * 1024, base, gw, ngw, scr, c.lane);
    }
    bf16_t* mn = WSP(bf16_t, A_MN);
    for (int r = gw; r < 1024; r += ngw) {
        const int l = r >> 9, mr = r & 511;
        const f32x4* xr = (const f32x4*)(p->in[2] + (size_t)mr * 1024) + c.lane; const f32x4* gr = (const f32x4*)(p->in[18] + (size_t)l * 1024) + c.lane;
        f32x4 v[4]; float s = 0.f;
#pragma unroll
        for (int j = 0; j < 4; ++j) { v[j] = xr[64 * j]; s += (v[j][0] * v[j][0] + v[j][1] * v[j][1]) + (v[j][2] * v[j][2] + v[j][3] * v[j][3]); }
        const float rs = rsqrtf(wave_sum(s) * (1.f / 1024.f) + EPS);
        u32x2* o = (u32x2*)(mn + (size_t)r * 1024) + c.lane;
#pragma unroll
        for (int j = 0; j < 4; ++j) { const f32x4 g = gr[64 * j]; u32x2 w; w.x = pk2(v[j][0] * rs * g[0], v[j][1] * rs * g[1]); w.y = pk2(v[j][2] * rs * g[2], v[j][3] * rs * g[3]); o[64 * j] = w; }
    }
}

__device__ __forceinline__ void phase_a(KP p, const Ctx& c0, const int l, const int mode) {
    const Ctx c = mkctx(c0);
    if (mode != 2) {
        LAS float* scr = (LAS float*)(c.lds + 40960 + c.wid * 8704);
        const int gw = c.bid * 8 + c.wid, ngw = c.G * 8;
        int base = 0;
        unsigned char* wb = p->ws + WS_W;
        tr_matrix<1>(p->in[11] + (size_t)l * 1024 * DIN, 1024, DIN, 3584, (bf16_t*)(wb + W_IN), base, gw, ngw, scr, c.lane);
        tr_matrix<0>(p->in[15] + (size_t)l * 1048576, 1024, 1024, 1024, (bf16_t*)(wb + W_OUT), base, gw, ngw, scr, c.lane);
        tr_matrix<0>(p->in[19] + (size_t)l * 1048576, 1024, 1024, 1024, (bf16_t*)(wb + W_MQ), base, gw, ngw, scr, c.lane);
        tr_matrix<0>(p->in[22] + (size_t)l * 1048576, 1024, 1024, 1024, (bf16_t*)(wb + W_MO), base, gw, ngw, scr, c.lane);
        tr_matrix<2>(p->in[25] + (size_t)l * 1024 * DUP, 1024, DUP, DUP, (bf16_t*)(wb + W_UP), base, gw, ngw, scr, c.lane);
        tr_matrix<0>(p->in[27] + (size_t)l * DFF * 1024, DFF, 1024, 1024, (bf16_t*)(wb + W_DOWN), base, gw, ngw, scr, c.lane);
        for (int bh = 0; bh < 64; ++bh) {
            const float* src = p->in[4] + ((size_t)(l * 16 + (bh >> 2)) * 256) * 1024 + (bh & 3) * 256;
            tr_matrix<0>(src, 256, 1024, 256, WSP(bf16_t, WS_MVS) + (size_t)bh * 65536, base, gw, ngw, scr, c.lane);
        }
        { const f32x4* src = (const f32x4*)(p->in[3] + (size_t)l * 16 * 256 * 1024); u32x2* dst = WSP(u32x2, WS_MKS);
          for (size_t i = (size_t)c.bid * 512 + c.tid; i < (size_t)16 * 256 * 256; i += (size_t)c.G * 512) { const f32x4 v = src[i]; u32x2 w; w.x = pk2(v[0], v[1]); w.y = pk2(v[2], v[3]); dst[i] = w; } }
    }
    LAS float* Wg = (LAS float*)c.lds; LAS float* ig = (LAS float*)(c.lds + 32768); LAS float* lf = ig + 256;
    if (mode != 2) {
        const float* win = p->in[11] + (size_t)l * 1024 * DIN + 3584;
        for (int i = c.tid; i < 8192; i += 512) { const int k = i >> 3, g = i & 7; Wg[g * 1024 + k] = win[(size_t)k * DIN + g]; }
    }
    __syncthreads();
    float bg[8];
#pragma unroll
    for (int g = 0; g < 8; ++g) bg[g] = (mode != 2) ? p->in[12][l * 8 + g] : 0.f;
    const f32x4* gpre = (const f32x4*)(p->in[10] + (size_t)(mode == 2 ? 0 : l) * 1024) + c.lane;
    const f32x4* gpost = (const f32x4*)(p->in[28] + (size_t)(l > 0 ? l - 1 : 0) * 1024) + c.lane;
    float* xres = p->out + O_Y; const float* yf = WSP(float, A_YF); bf16_t* xn = WSP(bf16_t, WS_R0);
    float* AAp = WSP(float, WS_AA); float* BCp = WSP(float, WS_BC); float* CHG = WSP(float, WS_CHG); float* CHA = WSP(float, WS_CHA);
    for (int ch = c.bid; ch < NCH; ch += c.G) {
        const int r0 = ch * 64;
        for (int i = 0; i < 8; ++i) {
            const int t = c.wid * 8 + i, row = r0 + t;
            f32x4 x[4];
            if (mode == 0) { const f32x4* xr = (const f32x4*)xin_row(p, row) + c.lane;
#pragma unroll
                for (int j = 0; j < 4; ++j) x[j] = xr[64 * j]; }
            else { const f32x4* xr = (const f32x4*)(xres + (size_t)row * 1024) + c.lane; const f32x4* yr = (const f32x4*)(yf + (size_t)row * 1024) + c.lane;
                f32x4 y[4]; float s = 0.f;
#pragma unroll
                for (int j = 0; j < 4; ++j) { x[j] = xr[64 * j]; y[j] = yr[64 * j]; s += (y[j][0] * y[j][0] + y[j][1] * y[j][1]) + (y[j][2] * y[j][2] + y[j][3] * y[j][3]); }
                const float rs = rsqrtf(wave_sum(s) * (1.f / 1024.f) + EPS);
                f32x4* xo = (f32x4*)(xres + (size_t)row * 1024) + c.lane;
#pragma unroll
                for (int j = 0; j < 4; ++j) { x[j] = x[j] + y[j] * rs * gpost[64 * j]; xo[64 * j] = x[j]; } }
            if (mode != 2) {
                float s = 0.f;
#pragma unroll
                for (int j = 0; j < 4; ++j) s += (x[j][0] * x[j][0] + x[j][1] * x[j][1]) + (x[j][2] * x[j][2] + x[j][3] * x[j][3]);
                const float rs = rsqrtf(wave_sum(s) * (1.f / 1024.f) + EPS);
                u32x2* o = (u32x2*)(xn + (size_t)row * 1024) + c.lane;
#pragma unroll
                for (int j = 0; j < 4; ++j) { x[j] = x[j] * rs * gpre[64 * j]; u32x2 w; w.x = pk2(x[j][0], x[j][1]); w.y = pk2(x[j][2], x[j][3]); o[64 * j] = w; }
                float gsum[8];
#pragma unroll
                for (int g = 0; g < 8; ++g) { float a = 0.f;
#pragma unroll
                    for (int j = 0; j < 4; ++j) { const f32x4 w = *(const LAS f32x4*)(Wg + g * 1024 + 4 * c.lane + 256 * j); a += (x[j][0] * w[0] + x[j][1] * w[1]) + (x[j][2] * w[2] + x[j][3] * w[3]); }
                    gsum[g] = wave_sum(a); }
                if (c.lane == 0) {
#pragma unroll
                    for (int h = 0; h < 4; ++h) { ig[h * 64 + t] = gsum[h] + bg[h]; const float f = gsum[4 + h] + bg[4 + h]; lf[h * 64 + t] = fminf(f, 0.f) - log1pf(__expf(-fabsf(f))); } }
            }
        }
        if (mode != 2) {
            __syncthreads();
            if (c.wid < 4) { const int h = c.wid, t = c.lane; float bc = lf[h * 64 + t];
#pragma unroll
                for (int o = 1; o < 64; o <<= 1) { const float pv = __shfl_up(bc, o); if (t >= o) bc += pv; }
                const float a = ig[h * 64 + t] - bc; AAp[(size_t)(r0 + t) * 4 + h] = a; BCp[(size_t)(r0 + t) * 4 + h] = bc;
                const float am = wave_max(a); if (t == 63) { CHG[ch * 4 + h] = bc; CHA[ch * 4 + h] = am; } }
            __syncthreads();
        }
    }
}

__device__ __forceinline__ void mscan(KP p, const Ctx& c0, const int l) {
    const Ctx c = mkctx(c0);
    const float* CHG = WSP(float, WS_CHG); const float* CHA = WSP(float, WS_CHA); float* MIN = WSP(float, WS_MIN); float* MOUT = WSP(float, WS_MOUT); float* WC = WSP(float, WS_WC);
    if (c.wid != 0) return;
    for (int role = c.bid; role < 9; role += c.G) {
        if (role < 8) {
            const int b = role >> 2, h = role & 3, j = c.lane; float Gq[4], Aq[4];
#pragma unroll
            for (int q = 0; q < 4; ++q) { const int ch = b * 256 + 4 * j + q; Gq[q] = CHG[ch * 4 + h]; Aq[q] = CHA[ch * 4 + h]; }
            float U = -INFINITY, Gs = 0.f;
#pragma unroll
            for (int q = 0; q < 4; ++q) { U = fmaxf(Gq[q] + Aq[q], Gq[q] + U); Gs += Gq[q]; }
            float eU = U, eG = Gs;
#pragma unroll
            for (int o = 1; o < 64; o <<= 1) { const float pU = __shfl_up(eU, o), pG = __shfl_up(eG, o); if (j >= o) { eU = fmaxf(eU, eG + pU); eG = eG + pG; } }
            float xU = __shfl_up(eU, 1), xG = __shfl_up(eG, 1); if (j == 0) { xU = -INFINITY; xG = 0.f; }
            float m = fmaxf(xU, xG + 0.f);
#pragma unroll
            for (int q = 0; q < 4; ++q) { const int ch = b * 256 + 4 * j + q; const float mi = m; m = Gq[q] + fmaxf(Aq[q], mi);
                MIN[ch * 4 + h] = mi; MOUT[ch * 4 + h] = m; WC[ch * 4 + h] = __expf(Gq[q] + mi - m); }
            if (j == 63) p->out[O_MPO + (size_t)(l * 2 + b) * 4 + h] = m;
        } else {
            const int b = c.lane >> 2, h = c.lane & 3, ch = 512 + b;
            const float G = CHG[ch * 4 + h], A = CHA[ch * 4 + h], mi = p->in[8][(size_t)(l * 16 + b) * 4 + h], m = G + fmaxf(A, mi);
            MIN[ch * 4 + h] = mi; MOUT[ch * 4 + h] = m; WC[ch * 4 + h] = __expf(G + mi - m);
            p->out[O_MSO + (size_t)(l * 16 + b) * 4 + h] = m;
        }
    }
}

__device__ __forceinline__ void phase_m2(KP p, const Ctx& c0, const int l) {
    const Ctx c = mkctx(c0);
    const bf16_t* IN = WSP(bf16_t, A_IN); bf16_t* UC = WSP(bf16_t, A_UC); bf16_t* Y = WSP(bf16_t, A_Y);
    const float* AAp = WSP(float, WS_AA); const float* CHG = WSP(float, WS_CHG); const float* MOUT = WSP(float, WS_MOUT); float* NU = WSP(float, WS_NU);
    LAS bf16_t* Kt = (LAS bf16_t*)c.lds; LAS bf16_t* Vt = Kt + 128 * 72; LAS float* wsl = (LAS float*)(c.lds + 36864);
    const int fr = c.lane & 15, fq = c.lane >> 4;
    for (int it = c.bid; it < NITEM; it += c.G) {
        const int ch = it >> 2, h = it & 3, r0 = ch * 64;
        if (c.tid < 64) wsl[c.tid] = __expf(CHG[it] + AAp[(size_t)(r0 + c.tid) * 4 + h] - MOUT[it]) * KSCALE;
        __syncthreads();
#pragma unroll
        for (int i = 0; i < 2; ++i) { const int pc = c.tid + 512 * i, s = pc >> 4, dc = pc & 15;
            const bf16_t* rp = IN + (size_t)(r0 + s) * INW + 128 * h + 8 * dc;
            const u32x4 kv = *(const u32x4*)(rp + 1536), vv = *(const u32x4*)(rp + 2048);
            float kf[8], vf[8]; unpack8(kv, kf); unpack8(vv, vf); const float w = wsl[s];
#pragma unroll
            for (int j = 0; j < 8; ++j) { Kt[(8 * dc + j) * 72 + s] = (bf16_t)f2bf(kf[j] * w); Vt[(8 * dc + j) * 72 + s] = (bf16_t)f2bf(vf[j]); } }
        __syncthreads();
        {
            bf16x8 bv[2];
#pragma unroll
            for (int kk = 0; kk < 2; ++kk) bv[kk] = *(const LAS bf16x8*)(Vt + (16 * c.wid + fr) * 72 + 32 * kk + 8 * fq);
            bf16_t* ub = UC + (size_t)it * 16384 + (size_t)(16 * c.wid + fr) * 128 + 4 * fq;
#pragma unroll
            for (int dt = 0; dt < 8; ++dt) { f32x4 a = (f32x4){0.f, 0.f, 0.f, 0.f};
#pragma unroll
                for (int kk = 0; kk < 2; ++kk) { const bf16x8 ak = *(const LAS bf16x8*)(Kt + (16 * dt + fr) * 72 + 32 * kk + 8 * fq); a = __builtin_amdgcn_mfma_f32_16x16x32_bf16(ak, bv[kk], a, 0, 0, 0); }
                u32x2 w; w.x = pk2(a[0], a[1]); w.y = pk2(a[2], a[3]); *(u32x2*)(ub + 16 * dt) = w; }
            if (c.tid < 128) { float s = 0.f;
#pragma unroll
                for (int q = 0; q < 8; ++q) { const u32x4 w = *(const LAS u32x4*)(Kt + c.tid * 72 + 8 * q); float f[8]; unpack8(w, f);
#pragma unroll
                    for (int j = 0; j < 8; ++j) s += f[j]; }
                NU[(size_t)it * 128 + c.tid] = s; }
        }
        __syncthreads();
    }
    {
        const int c8 = c.lane * 8; float cw[3][8];
#pragma unroll
        for (int t = 0; t < 3; ++t)
#pragma unroll
            for (int j = 0; j < 8; ++j) cw[t][j] = p->in[13][((size_t)l * 3 + t) * 512 + c8 + j];
        for (int ci = c.bid; ci < NCH; ci += c.G) {
            const int rw = ci * 64 + 8 * c.wid; const bool seqstart = (ci >= 512) || ((ci & 255) == 0);
            float p2[8], p1[8];
            if (c.wid == 0 && seqstart) {
                if (ci >= 512) { const float* sc = p->in[5] + ((size_t)(l * 16 + (ci - 512)) * 2) * 512 + c8;
#pragma unroll
                    for (int j = 0; j < 8; ++j) { p2[j] = sc[j]; p1[j] = sc[512 + j]; } }
                else {
#pragma unroll
                    for (int j = 0; j < 8; ++j) { p2[j] = 0.f; p1[j] = 0.f; } }
            } else { unpack8(*(const u32x4*)(IN + (size_t)(rw - 2) * INW + c8), p2); unpack8(*(const u32x4*)(IN + (size_t)(rw - 1) * INW + c8), p1); }
#pragma unroll
            for (int i = 0; i < 8; ++i) { const size_t row = rw + i; float u[8], gb[8];
                unpack8(*(const u32x4*)(IN + row * INW + c8), u); unpack8(*(const u32x4*)(IN + row * INW + 512 + c8), gb);
                float y[8];
#pragma unroll
                for (int j = 0; j < 8; ++j) { y[j] = gb[j] * (cw[0][j] * p2[j] + cw[1][j] * p1[j] + cw[2][j] * u[j]); p2[j] = p1[j]; p1[j] = u[j]; }
                u32x4 w; w.x = pk2(y[0], y[1]); w.y = pk2(y[2], y[3]); w.z = pk2(y[4], y[5]); w.w = pk2(y[6], y[7]);
                *(u32x4*)(Y + row * 1024 + c8) = w; }
        }
    }
}

__device__ __forceinline__ void phase_m3(KP p, const Ctx& c0, const int l) {
    const Ctx c = mkctx(c0);
    bf16_t* UC = WSP(bf16_t, A_UC); const float* WC = WSP(float, WS_WC); float* NST = WSP(float, WS_NST); const float* NU = WSP(float, WS_NU);
    for (int role = c.bid; role < 194; role += c.G) {
#ifdef M3MASK
        if (!((M3MASK >> (role < 128 ? 0 : role < 192 ? 1 : 2)) & 1)) continue;
#endif
        if (role < 128) {
            const int chain = role >> 4, b = chain >> 2, h = chain & 3, el = ((role & 15) * 512 + c.tid) * 2;
            unsigned* base = (unsigned*)(UC + el);
            float c0 = 0.f, c1 = 0.f;
            for (int cc = 0; cc < 256; cc += 16) {
                unsigned u[16];
#pragma unroll
                for (int q = 0; q < 16; ++q) u[q] = base[(size_t)(((b * 256 + cc + q) * 4 + h)) * 8192];
#pragma unroll
                for (int q = 0; q < 16; ++q) { const int it = (b * 256 + cc + q) * 4 + h; const float w = WC[it];
                    base[(size_t)it * 8192] = pk2(c0, c1); c0 = w * c0 + bflo(u[q]); c1 = w * c1 + bfhi(u[q]); }
            }
            const int e = el >> 7, d = el & 127; float* oc = p->out + O_CP + ((size_t)(l * 2 + b) * 4 + h) * 16384;
            oc[(size_t)d * 128 + e] = c0; oc[(size_t)(d + 1) * 128 + e] = c1;
        } else if (role < 192) {
            const int sc = role - 128, b = sc >> 2, h = sc & 3, it = (512 + b) * 4 + h; const float w = WC[it];
            LAS float* T = (LAS float*)c.lds;
            const float* c0p = p->in[6] + ((size_t)(l * 16 + b) * 4 + h) * 16384;
            for (int i = c.tid; i < 16384; i += 512) T[(i >> 7) * 129 + (i & 127)] = c0p[i];
            __syncthreads();
            bf16_t* ub = UC + (size_t)it * 16384;
            for (int i = c.tid; i < 16384; i += 512) { const int e = i >> 7, d = i & 127; const float cv = T[d * 129 + e]; const float u = bf2f(ub[i]);
                ub[i] = (bf16_t)f2bf(cv); T[d * 129 + e] = w * cv + u; }
            __syncthreads();
            float* oc = p->out + O_CS + ((size_t)(l * 16 + b) * 4 + h) * 16384;
            for (int i = c.tid; i < 16384; i += 512) oc[i] = T[(i >> 7) * 129 + (i & 127)];
            if (c.tid < 128) { const float n0 = p->in[7][((size_t)(l * 16 + b) * 4 + h) * 128 + c.tid]; NST[(size_t)it * 128 + c.tid] = n0;
                p->out[O_NS + ((size_t)(l * 16 + b) * 4 + h) * 128 + c.tid] = w * n0 + NU[(size_t)it * 128 + c.tid]; }
            __syncthreads();
        } else {
            const int id = (role - 192) * 512 + c.tid, chain = id >> 7, d = id & 127, b = chain >> 2, h = chain & 3;
            float n = 0.f;
            for (int cc = 0; cc < 256; cc += 16) { float nu[16], wv[16];
#pragma unroll
                for (int q = 0; q < 16; ++q) { const int it = (b * 256 + cc + q) * 4 + h; nu[q] = NU[(size_t)it * 128 + d]; wv[q] = WC[it]; }
#pragma unroll
                for (int q = 0; q < 16; ++q) { const int it = (b * 256 + cc + q) * 4 + h; NST[(size_t)it * 128 + d] = n; n = wv[q] * n + nu[q]; } }
            p->out[O_NP + ((size_t)(l * 2 + b) * 4 + h) * 128 + d] = n;
        }
    }
}

__device__ __forceinline__ void phase_m4(KP p, const Ctx& c0, const int l) {
    const Ctx c = mkctx(c0);
    const bf16_t* IN = WSP(bf16_t, A_IN); const bf16_t* UC = WSP(bf16_t, A_UC); bf16_t* Y = WSP(bf16_t, A_Y);
    const float* AAp = WSP(float, WS_AA); const float* BCp = WSP(float, WS_BC); const float* MIN = WSP(float, WS_MIN); const float* NST = WSP(float, WS_NST);
    const int sub = c.wid >> 2, rs = c.wid & 3, ts = c.tid & 255, fr = c.lane & 15, fq = c.lane >> 4;
    LAS unsigned char* sb = c.lds + sub * 28672;
    LAS bf16_t* Vt = (LAS bf16_t*)sb; LAS bf16_t* SD = (LAS bf16_t*)(sb + 18432 + rs * 2304); LAS float* aL = (LAS float*)(sb + 27648); LAS float* muL = aL + 64; LAS float* bcL = aL + 128;
    const float* nw = p->in[14] + (size_t)l * 512;
    for (int pi = c.bid; pi < NITEM / 2; pi += c.G) {
        const int it = 2 * pi + sub, ch = it >> 2, h = it & 3, r0 = ch * 64; const float m_in = MIN[it];
#pragma unroll
        for (int i = 0; i < 4; ++i) { const int pc = ts + 256 * i, s = pc >> 4, dc = pc & 15;
            const u32x4 vv = *(const u32x4*)(IN + (size_t)(r0 + s) * INW + 2048 + 128 * h + 8 * dc); float vf[8]; unpack8(vv, vf);
#pragma unroll
            for (int j = 0; j < 8; ++j) Vt[(8 * dc + j) * 72 + s] = (bf16_t)f2bf(vf[j]); }
        if (rs == 0) { const int t = c.lane; const float a = AAp[(size_t)(r0 + t) * 4 + h]; float cm = a;
#pragma unroll
            for (int o = 1; o < 64; o <<= 1) { const float pv = __shfl_up(cm, o); if (t >= o) cm = fmaxf(cm, pv); }
            aL[t] = a; muL[t] = fmaxf(cm, m_in); bcL[t] = BCp[(size_t)(r0 + t) * 4 + h]; }
        __syncthreads();
        bf16x8 aq[4];
        { const bf16_t* qp = IN + (size_t)(r0 + 16 * rs + fr) * INW + 1024 + 128 * h + 8 * fq;
#pragma unroll
          for (int kk = 0; kk < 4; ++kk) aq[kk] = *(const bf16x8*)(qp + 32 * kk); }
        float rowsum[4] = {0.f, 0.f, 0.f, 0.f};
#pragma unroll
        for (int st = 0; st < 4; ++st) {
            f32x4 sacc = (f32x4){0.f, 0.f, 0.f, 0.f};
            if (st <= rs) { const bf16_t* kp = IN + (size_t)(r0 + 16 * st + fr) * INW + 1536 + 128 * h + 8 * fq;
#pragma unroll
                for (int kk = 0; kk < 4; ++kk) { const bf16x8 bk = *(const bf16x8*)(kp + 32 * kk); sacc = __builtin_amdgcn_mfma_f32_16x16x32_bf16(aq[kk], bk, sacc, 0, 0, 0); } }
            const int s = 16 * st + fr; const float as = aL[s];
#pragma unroll
            for (int r = 0; r < 4; ++r) { const int t = 16 * rs + 4 * fq + r; float v = 0.f;
                if (st <= rs && s <= t) v = sacc[r] * KSCALE * __expf(as - muL[t]);
                const unsigned pb = f2bf(v); rowsum[r] += bf2f(pb); SD[(4 * fq + r) * 72 + s] = (bf16_t)pb; }
        }
#pragma unroll
        for (int r = 0; r < 4; ++r) { float v = rowsum[r]; v += __shfl_xor(v, 1); v += __shfl_xor(v, 2); v += __shfl_xor(v, 4); v += __shfl_xor(v, 8); rowsum[r] = v; }
        LDS_WAIT(); asm volatile("" ::: "memory");
        f32x4 accN[8], accC[8], accQ = (f32x4){0.f, 0.f, 0.f, 0.f};
#pragma unroll
        for (int et = 0; et < 8; ++et) { accN[et] = (f32x4){0.f, 0.f, 0.f, 0.f}; accC[et] = (f32x4){0.f, 0.f, 0.f, 0.f}; }
#pragma unroll
        for (int kk = 0; kk < 2; ++kk) { const bf16x8 ap = *(const LAS bf16x8*)(SD + fr * 72 + 32 * kk + 8 * fq);
#pragma unroll
            for (int et = 0; et < 8; ++et) { const bf16x8 bv = *(const LAS bf16x8*)(Vt + (16 * et + fr) * 72 + 32 * kk + 8 * fq); accN[et] = __builtin_amdgcn_mfma_f32_16x16x32_bf16(ap, bv, accN[et], 0, 0, 0); } }
        { const bf16_t* cb = UC + (size_t)it * 16384 + (size_t)fr * 128 + 8 * fq; const float* nb = NST + (size_t)it * 128 + 8 * fq;
#pragma unroll
          for (int kk = 0; kk < 4; ++kk) {
#pragma unroll
              for (int et = 0; et < 8; ++et) { const bf16x8 bc8 = *(const bf16x8*)(cb + (size_t)et * 2048 + 32 * kk); accC[et] = __builtin_amdgcn_mfma_f32_16x16x32_bf16(aq[kk], bc8, accC[et], 0, 0, 0); }
              const f32x4 n0 = *(const f32x4*)(nb + 32 * kk), n1 = *(const f32x4*)(nb + 32 * kk + 4);
              u32x4 nwv; nwv.x = pk2(n0[0], n0[1]); nwv.y = pk2(n0[2], n0[3]); nwv.z = pk2(n1[0], n1[1]); nwv.w = pk2(n1[2], n1[3]);
              if (fr != 0) nwv = (u32x4){0u, 0u, 0u, 0u};
              accQ = __builtin_amdgcn_mfma_f32_16x16x32_bf16(aq[kk], __builtin_bit_cast(bf16x8, nwv), accQ, 0, 0, 0); } }
        float winter[4], inv[4], ss[4];
#pragma unroll
        for (int r = 0; r < 4; ++r) { const int t = 16 * rs + 4 * fq + r; const float mu = muL[t]; winter[r] = __expf(m_in - mu);
            const float qn = __shfl(accQ[r], c.lane & 48); const float den = rowsum[r] + winter[r] * qn;
            inv[r] = 1.f / fmaxf(fabsf(den), __expf(-(bcL[t] + mu))); ss[r] = 0.f; }
#pragma unroll
        for (int et = 0; et < 8; ++et)
#pragma unroll
            for (int r = 0; r < 4; ++r) { const float hv = (accN[et][r] + winter[r] * accC[et][r]) * inv[r]; accN[et][r] = hv; ss[r] += hv * hv; }
#pragma unroll
        for (int r = 0; r < 4; ++r) { float v = ss[r]; v += __shfl_xor(v, 1); v += __shfl_xor(v, 2); v += __shfl_xor(v, 4); v += __shfl_xor(v, 8); ss[r] = rsqrtf(v * (1.f / 128.f) + EPS); }
#pragma unroll
        for (int et = 0; et < 8; ++et) { const int e = 16 * et + fr; const float g = nw[128 * h + e];
#pragma unroll
            for (int r = 0; r < 4; ++r) { const size_t row = (size_t)r0 + 16 * rs + 4 * fq + r; const float o = bf2f(IN[row * INW + 2560 + 128 * h + e]);
                const float sg = 1.f / (1.f + __expf(-o)); Y[row * 1024 + 512 + 128 * h + e] = (bf16_t)f2bf(accN[et][r] * ss[r] * g * sg); } }
        __syncthreads();
    }
}

__device__ __forceinline__ void phase_n(KP p, const Ctx& c0, const int l, const float* gpost_, const float* gpre_, const bool x_from_input) {
    const Ctx c = mkctx(c0);
    const f32x4* gpost = (const f32x4*)gpost_ + c.lane; const f32x4* gpre = (const f32x4*)gpre_ + c.lane;
    float* xres = p->out + O_Y; const float* yf = WSP(float, A_YF); bf16_t* xn = WSP(bf16_t, WS_R0);
    for (int row = c.bid * 8 + c.wid; row < MROWS; row += c.G * 8) {
        const f32x4* xr = (const f32x4*)(x_from_input ? xin_row(p, row) : xres + (size_t)row * 1024) + c.lane; const f32x4* yr = (const f32x4*)(yf + (size_t)row * 1024) + c.lane;
        f32x4 x[4], y[4]; float s = 0.f;
#pragma unroll
        for (int j = 0; j < 4; ++j) { x[j] = xr[64 * j]; y[j] = yr[64 * j]; s += (y[j][0] * y[j][0] + y[j][1] * y[j][1]) + (y[j][2] * y[j][2] + y[j][3] * y[j][3]); }
        const float rs = rsqrtf(wave_sum(s) * (1.f / 1024.f) + EPS);
        f32x4* xo = (f32x4*)(xres + (size_t)row * 1024) + c.lane; float s2 = 0.f;
#pragma unroll
        for (int j = 0; j < 4; ++j) { x[j] = x[j] + y[j] * rs * gpost[64 * j]; xo[64 * j] = x[j]; s2 += (x[j][0] * x[j][0] + x[j][1] * x[j][1]) + (x[j][2] * x[j][2] + x[j][3] * x[j][3]); }
        const float r2 = rsqrtf(wave_sum(s2) * (1.f / 1024.f) + EPS);
        u32x2* o = (u32x2*)(xn + (size_t)row * 1024) + c.lane;
#pragma unroll
        for (int j = 0; j < 4; ++j) { const f32x4 v = x[j] * r2 * gpre[64 * j]; u32x2 w; w.x = pk2(v[0], v[1]); w.y = pk2(v[2], v[3]); o[64 * j] = w; }
    }
}

__device__ __forceinline__ void phase_cv(KP p, const Ctx& c0, const int l, const int gi) {
    const Ctx c = mkctx(c0);
    const bf16_t* UP = WSP(bf16_t, A_UP); bf16_t* ACT = WSP(bf16_t, A_ACT);
    const float* fw = p->in[26] + (size_t)l * 3 * DUP;
    for (int ci = c.bid; ci < NCH; ci += c.G) {
        const int rw = ci * 64 + 8 * c.wid; const bool seqstart = (ci >= 512) || ((ci & 255) == 0);
        for (int cgp = c.lane; cgp < 176; cgp += 64) {
            const int jl = cgp >> 4, w8 = (cgp & 15) * 8, ca = 128 * (11 * gi + jl) + w8, cgn = DFF + ca, uc = 256 * jl + w8;
            float wa[3][8], wg[3][8];
#pragma unroll
            for (int t = 0; t < 3; ++t)
#pragma unroll
                for (int j = 0; j < 8; ++j) { wa[t][j] = fw[(size_t)t * DUP + ca + j]; wg[t][j] = fw[(size_t)t * DUP + cgn + j]; }
            float a2[8], a1[8], g2[8], g1[8];
            if (c.wid == 0 && seqstart) {
                if (ci >= 512) { const float* sc = p->in[9] + ((size_t)(l * 16 + (ci - 512)) * 2) * DUP;
#pragma unroll
                    for (int j = 0; j < 8; ++j) { a2[j] = sc[ca + j]; g2[j] = sc[cgn + j]; a1[j] = sc[DUP + ca + j]; g1[j] = sc[DUP + cgn + j]; } }
                else {
#pragma unroll
                    for (int j = 0; j < 8; ++j) { a2[j] = 0.f; a1[j] = 0.f; g2[j] = 0.f; g1[j] = 0.f; } }
            } else {
                unpack8(*(const u32x4*)(UP + (size_t)(rw - 2) * DFF + uc), a2); unpack8(*(const u32x4*)(UP + (size_t)(rw - 2) * DFF + uc + 128), g2);
                unpack8(*(const u32x4*)(UP + (size_t)(rw - 1) * DFF + uc), a1); unpack8(*(const u32x4*)(UP + (size_t)(rw - 1) * DFF + uc + 128), g1);
            }
#pragma unroll
            for (int i = 0; i < 8; ++i) { const size_t row = rw + i; float a0[8], g0[8], y[8];
                unpack8(*(const u32x4*)(UP + row * DFF + uc), a0); unpack8(*(const u32x4*)(UP + row * DFF + uc + 128), g0);
#pragma unroll
                for (int j = 0; j < 8; ++j) { const float ac = wa[0][j] * a2[j] + wa[1][j] * a1[j] + wa[2][j] * a0[j]; const float gc = wg[0][j] * g2[j] + wg[1][j] * g1[j] + wg[2][j] * g0[j];
                    y[j] = gelu_tanh(gc) * ac; a2[j] = a1[j]; a1[j] = a0[j]; g2[j] = g1[j]; g1[j] = g0[j]; }
                u32x4 w; w.x = pk2(y[0], y[1]); w.y = pk2(y[2], y[3]); w.z = pk2(y[4], y[5]); w.w = pk2(y[6], y[7]);
                *(u32x4*)(ACT + row * DFF + ca) = w; }
        }
    }
}

__global__ void __launch_bounds__(512, 2) fwd_megakernel(Params p_unused) {
    extern __shared__ __attribute__((aligned(16))) unsigned char lds_raw[];
    cg::grid_group grid = cg::this_grid();
    Ctx c; c.lds = (LAS unsigned char*)lds_raw; c.tid = 0; c.lane = 0; c.wid = __builtin_amdgcn_readfirstlane((int)threadIdx.x >> 6); c.G = gridDim.x; c.bid = blockIdx.x;
    LAS unsigned char* xl = c.lds + XL_OFF;
#define WB (p->ws + WS_W)
    volatile LAS unsigned* bst = (volatile LAS unsigned*)(c.lds + LDS_BYTES - 64);
    if (threadIdx.x < 2) bst[threadIdx.x] = 0u;
    __syncthreads();
    XcdBarrier xbar = xcd_barrier_post((unsigned*)(kp_new()->ws + WS_CTL), bst, c.wid);
#define GSYNC() xcd_barrier(xbar, c.wid)

    phase_p0(kp_new(), c);
    asm volatile("s_waitcnt vmcnt(0) lgkmcnt(0)" ::: "memory"); __syncthreads();
    grid.sync();
    if (STOP_AT == 1) return;
    {
        KP p = kp_new();
        pg8::MemKvOrder S{(const char*)(p->ws + A_MN), (const char*)(p->ws + A_WKV), c.G, c.bid};
        pg8::EpiMemKv E{p->out + O_MK, p->out + O_MV, WSP(bf16_t, WS_MKP), WSP(bf16_t, WS_MVP)};
        pg8::gemm_phase<pg8::EpiMemKv, pg8::MemKvOrder, false>(c.lds, xl, c.wid, 1024, 1024, 1024, S, E);
    }
    GSYNC();
    if (STOP_AT == 2) return;
    for (int l = 0; l < 2; ++l) {
        phase_a(kp_new(), c, l, l == 0 ? 0 : 1);
        GSYNC();
    if (STOP_AT == 3) return;
        {
            KP p = kp_new();
            mscan(p, c, l);
            pg8::TileOrder S; S.init(p->ws + WS_R0, (size_t)256 * 2048, WB + W_IN, (size_t)256 * 2048, NTM, 14, c.G, c.bid);
            pg8::EpiIn E{WSP(bf16_t, A_IN), p->out + O_CONVP + (size_t)l * 2048, p->out + O_CONVS + (size_t)l * 16384};
            pg8::gemm_phase<pg8::EpiIn, pg8::TileOrder, true>(c.lds, xl, c.wid, 1024, 1024, 1024, S, E);
        }
        GSYNC();
    if (STOP_AT == 4) return;
        phase_m2(kp_new(), c, l);
        GSYNC();
    if (STOP_AT == 5) return;
        phase_m3(kp_new(), c, l);
        GSYNC();
    if (STOP_AT == 6) return;
        phase_m4(kp_new(), c, l);
        GSYNC();
    if (STOP_AT == 7) return;
        {
            KP p = kp_new();
            pg8::TileOrder S; S.init(p->ws + A_Y, (size_t)256 * 2048, WB + W_OUT, (size_t)256 * 2048, NTM, 4, c.G, c.bid);
            pg8::EpiF32 E{WSP(float, A_YF)};
            pg8::gemm_phase<pg8::EpiF32, pg8::TileOrder, true>(c.lds, xl, c.wid, 1024, 1024, 1024, S, E);
        }
        GSYNC();
    if (STOP_AT == 8) return;
        { KP p = kp_new(); phase_n(p, c, l, p->in[16] + (size_t)l * 1024, p->in[17] + (size_t)l * 1024, l == 0); }
        GSYNC();
    if (STOP_AT == 9) return;
        {
            KP p = kp_new();
            pg8::TileOrder S; S.init(p->ws + WS_R0, (size_t)256 * 2048, WB + W_MQ, (size_t)256 * 2048, NTM, 4, c.G, c.bid);
            pg8::EpiBf16 E{WSP(bf16_t, A_Q2), 1024, 0.0625f};
            pg8::gemm_phase<pg8::EpiBf16, pg8::TileOrder, true>(c.lds, xl, c.wid, 1024, 1024, 1024, S, E);
        }
        GSYNC();
    if (STOP_AT == 10) return;
        {
            KP p = kp_new();
            pg8::AttnOrder S{(const char*)(p->ws + A_Q2), (const char*)(p->ws + WS_MKP + (size_t)l * 1048576), (const char*)(p->ws + WS_MKS), (size_t)256 * 2048, (size_t)512, c.G, c.bid};
            pg8::EpiSoftmax E{WSP(bf16_t, A_P)};
            pg8::gemm_phase<pg8::EpiSoftmax, pg8::AttnOrder, true>(c.lds, xl, c.wid, 256, 1024, 1024, S, E);
        }
        GSYNC();
    if (STOP_AT == 11) return;
        {
            KP p = kp_new();
            pg8::AttnOrder S{(const char*)(p->ws + A_P), (const char*)(p->ws + WS_MVP + (size_t)l * 1048576), (const char*)(p->ws + WS_MVS), (size_t)4 * 131072, (size_t)131072, c.G, c.bid};
            pg8::EpiBf16 E{WSP(bf16_t, A_O2), 1024, 1.f};
            pg8::gemm_phase<pg8::EpiBf16, pg8::AttnOrder, true>(c.lds, xl, c.wid, 256, 1024, 256, S, E);
        }
        GSYNC();
    if (STOP_AT == 12) return;
        {
            KP p = kp_new();
            pg8::TileOrder S; S.init(p->ws + A_O2, (size_t)256 * 2048, WB + W_MO, (size_t)256 * 2048, NTM, 4, c.G, c.bid);
            pg8::EpiF32 E{WSP(float, A_YF)};
            pg8::gemm_phase<pg8::EpiF32, pg8::TileOrder, true>(c.lds, xl, c.wid, 1024, 1024, 1024, S, E);
        }
        GSYNC();
    if (STOP_AT == 13) return;
        { KP p = kp_new(); phase_n(p, c, l, p->in[23] + (size_t)l * 1024, p->in[24] + (size_t)l * 1024, false); }
        GSYNC();
    if (STOP_AT == 14) return;
        for (int gi = 0; gi < 2; ++gi) {
            {
                KP p = kp_new();
                pg8::TileOrder S; S.init(p->ws + WS_R0, (size_t)256 * 2048, WB + W_UP + (size_t)gi * DFF * 2048, (size_t)256 * 2048, NTM, 11, c.G, c.bid);
                pg8::EpiUp E{WSP(bf16_t, A_UP), gi, p->out + O_FFP + (size_t)l * 2 * 2 * DUP, p->out + O_FFS + (size_t)l * 16 * 2 * DUP};
                pg8::gemm_phase<pg8::EpiUp, pg8::TileOrder, true>(c.lds, xl, c.wid, 1024, 1024, 1024, S, E);
            }
            GSYNC();
    if (STOP_AT == 15) return;
            phase_cv(kp_new(), c, l, gi);
            GSYNC();
    if (STOP_AT == 16) return;
        }
        {
            KP p = kp_new();
            pg8::TileOrder S; S.init(p->ws + A_ACT, (size_t)256 * DFF * 2, WB + W_DOWN, (size_t)256 * DFF * 2, NTM, 4, c.G, c.bid);
            pg8::EpiF32 E{WSP(float, A_YF)};
            pg8::gemm_phase<pg8::EpiF32, pg8::TileOrder, true>(c.lds, xl, c.wid, DFF, DFF, DFF, S, E);
        }
        GSYNC();
    if (STOP_AT == 17) return;
    }
    phase_a(kp_new(), c, 2, 2);
#undef WB
#undef GSYNC
}

extern "C" void kernel_launch(void* const* d_in, const int* in_sizes, int n_in, void* d_out, int out_size, void* d_ws, size_t ws_size, hipStream_t stream) {
    static int grid = 0;
    if (grid == 0) {
        if (n_in != 29 || out_size != (int)O_END || ws_size < WS_END) { fprintf(stderr, "kernel_launch: unexpected sizes n_in %d out %d ws %zu (need %zu)\n", n_in, out_size, ws_size, (size_t)WS_END); grid = -1; return; }
        int dev = 0, cus = 0, per_cu = 0;
        (void)hipGetDevice(&dev); (void)hipDeviceGetAttribute(&cus, hipDeviceAttributeMultiprocessorCount, dev);
        if (hipFuncSetAttribute((const void*)fwd_megakernel, hipFuncAttributeMaxDynamicSharedMemorySize, LDS_BYTES) != hipSuccess) { fprintf(stderr, "kernel_launch: hipFuncSetAttribute failed\n"); grid = -1; return; }
        if (hipOccupancyMaxActiveBlocksPerMultiprocessor(&per_cu, (const void*)fwd_megakernel, 512, LDS_BYTES) != hipSuccess || per_cu < 1) { fprintf(stderr, "kernel_launch: occupancy query failed (%d)\n", per_cu); (void)hipGetLastError(); grid = -1; return; }
        grid = cus * 1;
        fprintf(stderr, "kernel_launch: grid %d (cus %d, per_cu %d)\n", grid, cus, per_cu);
    }
    if (grid < 0) return;
    if (hipMemsetAsync((char*)d_ws + WS_CTL, 0, 65536, stream) != hipSuccess) { fprintf(stderr, "kernel_launch: memset failed\n"); return; }
    Params prm{};
    for (int i = 0; i < 29; ++i) prm.in[i] = (const float*)d_in[i];
    prm.out = (float*)d_out; prm.ws = (unsigned char*)d_ws;
    void* args[] = {&prm};
    hipError_t e = hipLaunchCooperativeKernel((const void*)fwd_megakernel, dim3(grid), dim3(512), args, LDS_BYTES, stream);
    if (e != hipSuccess) fprintf(stderr, "kernel_launch: cooperative launch failed: %s (grid %d)\n", hipGetErrorString(e), grid);
}
```
